# Optimizing an MI355X kernel written in HIP

```python
import jax, jax.numpy as jnp
from jax import lax
import numpy as np

D_MODEL = 1024
BATCH = 2
SEQ = 8192
DEPTH = 2

CONV_WIDTH = D_MODEL
CONV_K = 3
ATTN_GROUPS = ((128, 1), (512, 4), (2048, 16))
HEADS_PER_GROUP = 8
HEAD_DIM = 64
ATTN_BLK = 128
ATTN_OUT = HEADS_PER_GROUP * HEAD_DIM
ROPE_THETA = 10000.0
GMLP_WIDTH = D_MODEL
GMLP_GROUPS = 8
GMLP_GROUP_DIM = GMLP_WIDTH // GMLP_GROUPS
GMLP_CHUNK = 128
D_FF = ((-(-8 * D_MODEL // 3)) + 255) // 256 * 256
ALPHA = (2 * DEPTH) ** 0.25
BETA = (8 * DEPTH) ** -0.25
LN_EPS = 1e-5

GROUP_COL = HEADS_PER_GROUP * HEAD_DIM
SPLIT_SIZES = ([D_MODEL] * 3 + [CONV_WIDTH] * 3 + [GROUP_COL] * (3 * len(ATTN_GROUPS)) + [GMLP_WIDTH] * 2)
N_IN = sum(SPLIT_SIZES)

kernel_name = 'hybrid_conv_dilattn_gmlp_deepnorm'


def layer_norm(x, g, b):
    x32 = x.astype(jnp.float32)
    mu = jnp.mean(x32, axis=-1, keepdims=True)
    var = jnp.mean(jnp.square(x32 - mu), axis=-1, keepdims=True)
    y = (x32 - mu) * lax.rsqrt(var + LN_EPS) * g.astype(jnp.float32) + b.astype(jnp.float32)
    return y.astype(x.dtype)


def rope(t, positions):
    half = HEAD_DIM // 2
    inv_freq = ROPE_THETA ** (-jnp.arange(half, dtype=jnp.float32) / half)
    ang = positions.astype(jnp.float32)[..., None] * inv_freq
    cos = jnp.cos(ang)[:, :, None, :]
    sin = jnp.sin(ang)[:, :, None, :]
    t32 = t.astype(jnp.float32)
    t1, t2 = t32[..., :half], t32[..., half:]
    return jnp.concatenate([t1 * cos - t2 * sin, t2 * cos + t1 * sin], axis=-1).astype(t.dtype)


def short_conv_mixer(b_gate, c_gate, h, conv_w):
    z = c_gate * h
    conv = lax.conv_general_dilated(
        z, conv_w[:, None, :].astype(z.dtype), window_strides=(1,), padding=[(CONV_K - 1, 0)],
        dimension_numbers=('NWC', 'WIO', 'NWC'), feature_group_count=CONV_WIDTH)
    return b_gate * conv


def dilated_window_attention(q, k, v, window, dil):
    B, S, H, Dh = q.shape
    steps = window // dil
    span = dil * ATTN_BLK
    s_pad = -(-S // span) * span
    L = s_pad // dil
    nb = L // ATTN_BLK
    pad = ((0, 0), (0, s_pad - S), (0, 0), (0, 0))

    def fold(a):
        a = jnp.pad(a, pad).reshape(B, L, dil, H, Dh).transpose(0, 2, 1, 3, 4)
        return a.reshape(B, dil, nb, ATTN_BLK, H, Dh)

    qb, kb, vb = fold(q), fold(k), fold(v)
    blk_pad = ((0, 0), (0, 0), (1, 0), (0, 0), (0, 0), (0, 0))
    kw = jnp.concatenate([jnp.pad(kb, blk_pad)[:, :, :-1], kb], axis=3)
    vw = jnp.concatenate([jnp.pad(vb, blk_pad)[:, :, :-1], vb], axis=3)
    s = jnp.einsum('brnqhd,brnkhd->brnhqk', qb, kw).astype(jnp.float32) * (HEAD_DIM ** -0.5)
    qi = jnp.arange(ATTN_BLK)[:, None] + ATTN_BLK
    ki = jnp.arange(2 * ATTN_BLK)[None, :]
    dist = qi - ki
    band = (dist >= 0) & (dist <= steps)
    first = (jnp.arange(nb)[:, None, None] == 0) & (ki[None] < ATTN_BLK)
    valid = band[None] & jnp.logical_not(first)
    s = jnp.where(valid[None, None, :, None], s, -jnp.inf)
    lse = jax.nn.logsumexp(s, axis=-1)
    p = jnp.exp(s - lse[..., None]).astype(v.dtype)
    o = jnp.einsum('brnhqk,brnkhd->brnqhd', p, vw)
    o = o.reshape(B, dil, L, H, Dh).transpose(0, 2, 1, 3, 4).reshape(B, s_pad, H, Dh)[:, :S]
    lse = lse.transpose(0, 1, 2, 4, 3).reshape(B, dil, L, H).transpose(0, 2, 1, 3).reshape(B, s_pad, H)[:, :S]
    return o, lse


def dilated_attention_mixer(qkv_parts, positions):
    B, S, _ = qkv_parts[0].shape
    outs, lses = [], []
    for g, (window, dil) in enumerate(ATTN_GROUPS):
        q = rope(qkv_parts[3 * g].reshape(B, S, HEADS_PER_GROUP, HEAD_DIM), positions)
        k = rope(qkv_parts[3 * g + 1].reshape(B, S, HEADS_PER_GROUP, HEAD_DIM), positions)
        v = qkv_parts[3 * g + 2].reshape(B, S, HEADS_PER_GROUP, HEAD_DIM)
        o, lse = dilated_window_attention(q, k, v, window, dil)
        outs.append(o)
        lses.append(lse)
    wts = jax.nn.softmax(jnp.stack(lses, axis=0), axis=0)
    o = sum(wts[g][..., None].astype(outs[g].dtype) * outs[g] for g in range(len(ATTN_GROUPS)))
    return o.reshape(B, S, ATTN_OUT)


def chunked_spatial_gating(u_pre, v_pre, ln_g, ln_b, w_s, b_s):
    B, S, _ = u_pre.shape
    u = jax.nn.gelu(u_pre, approximate=False)
    v = layer_norm(jax.nn.gelu(v_pre, approximate=False), ln_g, ln_b)
    n = S // GMLP_CHUNK
    vc = v.reshape(B, n, GMLP_CHUNK, GMLP_GROUPS, GMLP_GROUP_DIM)
    tril = jnp.tril(jnp.ones((GMLP_CHUNK, GMLP_CHUNK), dtype=w_s.dtype))
    w_causal = w_s * tril[None]
    sp = jnp.einsum('gij,bnjgc->bnigc', w_causal, vc) + b_s.T[None, None, :, :, None]
    return u * sp.reshape(B, S, GMLP_WIDTH)


def setup_inputs(seed: int = 0) -> dict:
    key = jax.random.key(seed)
    ks = jax.random.split(key, 24)
    f32 = jnp.float32

    def nrm(k, shape, fan_in, scale=1.0):
        return jax.random.normal(k, shape, f32) * (scale * fan_in ** -0.5)

    col_scale = np.ones((N_IN,), np.float32)
    off = 3 * D_MODEL + 3 * CONV_WIDTH
    for g in range(len(ATTN_GROUPS)):
        vs = off + (3 * g + 2) * GROUP_COL
        col_scale[vs:vs + GROUP_COL] = BETA
    x = jax.random.normal(ks[0], (BATCH, SEQ, D_MODEL), f32)
    offset = jax.random.randint(ks[1], (BATCH, 1), 0, 4096, dtype=jnp.int32)
    positions = (offset + jnp.arange(SEQ, dtype=jnp.int32)[None, :]).astype(jnp.int32)
    return {
        'x': x,
        'positions': positions,
        'w_in': nrm(ks[2], (DEPTH, D_MODEL, N_IN), D_MODEL) * jnp.asarray(col_scale),
        'conv_w': nrm(ks[3], (DEPTH, CONV_K, CONV_WIDTH), CONV_K),
        'gmlp_ln_g': 1.0 + 0.02 * jax.random.normal(ks[4], (DEPTH, GMLP_WIDTH), f32),
        'gmlp_ln_b': 0.02 * jax.random.normal(ks[5], (DEPTH, GMLP_WIDTH), f32),
        'w_s': nrm(ks[6], (DEPTH, GMLP_GROUPS, GMLP_CHUNK, GMLP_CHUNK), GMLP_CHUNK),
        'b_s': 1.0 + 0.1 * jax.random.normal(ks[7], (DEPTH, GMLP_GROUPS, GMLP_CHUNK), f32),
        'p_a': nrm(ks[8], (DEPTH, CONV_WIDTH, D_MODEL), CONV_WIDTH, BETA),
        'p_b': nrm(ks[9], (DEPTH, ATTN_OUT, D_MODEL), ATTN_OUT, BETA),
        'p_c': nrm(ks[10], (DEPTH, GMLP_WIDTH, D_MODEL), GMLP_WIDTH, BETA),
        'w_o': nrm(ks[11], (DEPTH, D_MODEL, D_MODEL), D_MODEL, BETA),
        'ln1_g': 1.0 + 0.02 * jax.random.normal(ks[12], (DEPTH, D_MODEL), f32),
        'ln1_b': 0.02 * jax.random.normal(ks[13], (DEPTH, D_MODEL), f32),
        'w_gate': nrm(ks[14], (DEPTH, D_MODEL, D_FF), D_MODEL),
        'w_up': nrm(ks[15], (DEPTH, D_MODEL, D_FF), D_MODEL, BETA),
        'w_down': nrm(ks[16], (DEPTH, D_FF, D_MODEL), D_FF, BETA),
        'ln2_g': 1.0 + 0.02 * jax.random.normal(ks[17], (DEPTH, D_MODEL), f32),
        'ln2_b': 0.02 * jax.random.normal(ks[18], (DEPTH, D_MODEL), f32),
    }


def reference(x, positions, w_in, conv_w, gmlp_ln_g, gmlp_ln_b, w_s, b_s, p_a, p_b, p_c, w_o,
              ln1_g, ln1_b, w_gate, w_up, w_down, ln2_g, ln2_b):
    split_points = np.cumsum(np.array(SPLIT_SIZES))[:-1].tolist()
    n_attn = 3 * len(ATTN_GROUPS)
    for l in range(DEPTH):
        proj = x @ w_in[l].astype(x.dtype)
        parts = jnp.split(proj, split_points, axis=-1)
        g_a, g_b, g_c = (jax.nn.sigmoid(p) for p in parts[0:3])
        y_a = short_conv_mixer(parts[3], parts[4], parts[5], conv_w[l])
        y_b = dilated_attention_mixer(parts[6:6 + n_attn], positions)
        y_c = chunked_spatial_gating(parts[6 + n_attn], parts[7 + n_attn], gmlp_ln_g[l], gmlp_ln_b[l],
                                     w_s[l], b_s[l])
        m = g_a * (y_a @ p_a[l]) + g_b * (y_b @ p_b[l]) + g_c * (y_c @ p_c[l])
        x = layer_norm(ALPHA * x + m @ w_o[l], ln1_g[l], ln1_b[l])
        h = jax.nn.silu(x @ w_gate[l]) * (x @ w_up[l])
        x = layer_norm(ALPHA * x + h @ w_down[l], ln2_g[l], ln2_b[l])
    return x
```

```cpp
#include <hip/hip_runtime.h>
#include <cstdint>
#include <cstdio>

namespace cfg {
constexpr int BATCH = 2, SEQ = 8192, D = 1024, T = BATCH * SEQ, NIN = 12800, DFF = 2816, DEPTH = 2;
constexpr int NH = 8, HD = 64, GC = 512;
constexpr float ALPHA = 1.4142135623730951f, LN_EPS = 1e-5f;
constexpr float QSCALE = 0.125f * 1.4426950408889634f;
constexpr int C_GATE = 0, C_B = 3072, C_C = 4096, C_H = 5120, C_ATT = 6144, C_U = 10752, C_V = 11776;
}
using namespace cfg;

typedef unsigned short bf16_t;
typedef short bf16x8 __attribute__((ext_vector_type(8)));
typedef float f32x4 __attribute__((ext_vector_type(4)));

__device__ __forceinline__ unsigned f2bf(float f) { unsigned u = __float_as_uint(f); return (u + 0x7fffu + ((u >> 16) & 1u)) >> 16; }
__device__ __forceinline__ float bf2f(unsigned h) { return __uint_as_float(h << 16); }
__device__ __forceinline__ float sigmoidf_(float x) { return 1.0f / (1.0f + __expf(-x)); }
__device__ __forceinline__ float gelu_exact(float x) { return 0.5f * x * (1.0f + erff(x * 0.70710678118654752f)); }
__device__ __forceinline__ int frow(int row, int dsh) { const int b = row >> 13, t = row & 8191; const int r = t & ((1 << dsh) - 1), j = t >> dsh; return (b << 13) + r * (8192 >> dsh) + j; }

constexpr size_t MiB = 1u << 20;
constexpr size_t WS_CTL = 0, WS_ROPE = 1 * MiB  , WS_LSE = 5 * MiB  , WS_STAT = 7 * MiB  ;
constexpr size_t WS_W = 12 * MiB;
constexpr size_t WS_XB = 62 * MiB;
constexpr size_t WS_BG = 94 * MiB, WS_Z = 126 * MiB;
constexpr size_t WS_Q = 158 * MiB;
constexpr size_t WS_K = 206 * MiB, WS_V = 254 * MiB;
constexpr size_t WS_U = 302 * MiB, WS_V2 = 334 * MiB;
constexpr size_t WS_G = WS_K, WS_M = WS_Z, WS_H = WS_Q;
constexpr size_t WS_END = 366 * MiB;
constexpr size_t QKV_STRIDE = (size_t)T * GC;

__device__ __constant__ double kInvFreq[32] = {
    1.0, 0.7498942093324559, 0.5623413251903491, 0.4216965034285822, 0.31622776601683794, 0.23713737056616552, 0.1778279410038923, 0.1333521432163324,
    0.1, 0.07498942093324558, 0.05623413251903491, 0.042169650342858224, 0.03162277660168379, 0.023713737056616554, 0.01778279410038923, 0.01333521432163324,
    0.01, 0.007498942093324558, 0.005623413251903491, 0.004216965034285823, 0.0031622776601683794, 0.0023713737056616554, 0.0017782794100389228, 0.001333521432163324,
    0.001, 0.0007498942093324559, 0.0005623413251903491, 0.00042169650342858224, 0.00031622776601683794, 0.00023713737056616554, 0.00017782794100389227, 0.0001333521432163324};

__device__ __forceinline__ void sincos_d(double a, float& s, float& c) {
    const double k = rint(a * 0.6366197723675814);
    double r = fma(-k, 1.5707963267948966, a); r = fma(-k, 6.123233995736766e-17, r);
    const double r2 = r * r;
    double sp = 2.7557319223985893e-06; sp = fma(sp, r2, -1.984126984126984e-04); sp = fma(sp, r2, 8.333333333333333e-03); sp = fma(sp, r2, -1.6666666666666666e-01); sp = fma(sp * r2, r, r);
    double cp = 2.48015873015873e-05; cp = fma(cp, r2, -1.388888888888889e-03); cp = fma(cp, r2, 4.1666666666666664e-02); cp = fma(cp, r2, -0.5); cp = fma(cp, r2, 1.0);
    sp = sp - 2.505210838544172e-08 * r2 * r2 * r2 * r2 * r2 * r;
    cp = cp - 2.755731922398589e-07 * r2 * r2 * r2 * r2 * r2;
    const long long q = (long long)k & 3;
    const double ss = (q == 0) ? sp : (q == 1) ? cp : (q == 2) ? -sp : -cp;
    const double cc = (q == 0) ? cp : (q == 1) ? -sp : (q == 2) ? -cp : sp;
    s = (float)ss; c = (float)cc;
}
__global__ void __launch_bounds__(256) k_rope_table(const int* __restrict__ pos, float* __restrict__ cs, float* __restrict__ sn) {
    const int idx = blockIdx.x * 256 + threadIdx.x; if (idx >= T * 32) return;
    const int row = idx >> 5, i = idx & 31; float s, c; sincos_d((double)pos[row] * kInvFreq[i], s, c); cs[idx] = c; sn[idx] = s;
}
__global__ void __launch_bounds__(256) k_cvt_x(const float* __restrict__ x, bf16_t* __restrict__ xb) {
    const size_t i = ((size_t)blockIdx.x * 256 + threadIdx.x) * 4; const f32x4 v = *(const f32x4*)(x + i);
    uint2 o; o.x = f2bf(v.x) | (f2bf(v.y) << 16); o.y = f2bf(v.z) | (f2bf(v.w) << 16); *(uint2*)(xb + i) = o;
}

template <class Epi> __global__ void __launch_bounds__(256) ngemm(const bf16_t* __restrict__ A, int K, Epi e) {
    const int lane = threadIdx.x & 63, w = threadIdx.x >> 6, c = lane & 15, q = lane >> 4;
    const int row0 = blockIdx.x * 64 + w * 16, job = blockIdx.y;
    f32x4 acc[Epi::NT]; const float* Wp[Epi::NT]; int ld[Epi::NT];
#pragma unroll
    for (int t = 0; t < Epi::NT; ++t) { acc[t] = (f32x4){0.f, 0.f, 0.f, 0.f}; Wp[t] = e.W(t) + e.col(job, t) + c; ld[t] = e.ldw(t); }
    const bf16_t* Ap = A + (size_t)(row0 + c) * K + 8 * q;
    for (int k0 = 0; k0 < K; k0 += 32) {
        const bf16x8 a = *(const bf16x8*)(Ap + k0);
#pragma unroll
        for (int t = 0; t < Epi::NT; ++t) { bf16x8 b;
#pragma unroll
            for (int j = 0; j < 8; ++j) b[j] = (short)f2bf(Wp[t][(size_t)(k0 + 8 * q + j) * ld[t]]);
            acc[t] = __builtin_amdgcn_mfma_f32_16x16x32_bf16(a, b, acc[t], 0, 0, 0); }
    }
#pragma unroll
    for (int r = 0; r < 4; ++r) { float v[Epi::NT];
#pragma unroll
        for (int t = 0; t < Epi::NT; ++t) v[t] = acc[t][r];
        e.store(job, row0 + 4 * q + r, c, v); }
}
enum { M_SIG = 0, M_PLAIN = 1, M_GELU = 2, M_FOLD = 3 };
template <int MODE> struct NE1 {
    static constexpr int NT = 1; const float* Wm; int ld_, cb; bf16_t* dst; int dld; int dsh;
    __device__ const float* W(int) const { return Wm; } __device__ int ldw(int) const { return ld_; } __device__ int col(int job, int) const { return cb + job * 16; }
    __device__ void store(int job, int row, int c, const float* v) const {
        float o = v[0]; if (MODE == M_SIG) o = sigmoidf_(o); if (MODE == M_GELU) o = gelu_exact(o);
        const int rr = (MODE == M_FOLD) ? frow(row, dsh) : row; dst[(size_t)rr * dld + job * 16 + c] = (bf16_t)f2bf(o); }
};
struct NEz {
    static constexpr int NT = 2; const float* Wm; bf16_t* dst;
    __device__ const float* W(int) const { return Wm; } __device__ int ldw(int) const { return NIN; } __device__ int col(int job, int t) const { return (t ? C_H : C_C) + job * 16; }
    __device__ void store(int job, int row, int c, const float* v) const { dst[(size_t)row * D + job * 16 + c] = (bf16_t)f2bf(v[0] * v[1]); }
};
struct NErope {
    static constexpr int NT = 2; const float* Wm; int cb; bf16_t* dst; int dsh; float scale; const float* cs; const float* sn;
    __device__ const float* W(int) const { return Wm; } __device__ int ldw(int) const { return NIN; } __device__ int col(int job, int t) const { return cb + (job >> 1) * 64 + (job & 1) * 16 + t * 32; }
    __device__ void store(int job, int row, int c, const float* v) const {
        const int i = (job & 1) * 16 + c, h = job >> 1; const float co = cs[row * 32 + i], si = sn[row * 32 + i];
        const float o1 = (v[0] * co - v[1] * si) * scale, o2 = (v[1] * co + v[0] * si) * scale; const size_t o = (size_t)frow(row, dsh) * GC + h * 64 + i;
        dst[o] = (bf16_t)f2bf(o1); dst[o + 32] = (bf16_t)f2bf(o2); }
};
struct NEres {
    static constexpr int NT = 1; const float* Wm; const float* res; float* out;
    __device__ const float* W(int) const { return Wm; } __device__ int ldw(int) const { return D; } __device__ int col(int job, int) const { return job * 16; }
    __device__ void store(int job, int row, int c, const float* v) const { const size_t o = (size_t)row * D + job * 16 + c; out[o] = ALPHA * res[o] + v[0]; }
};
struct NEffn {
    static constexpr int NT = 2; const float* Wg; const float* Wu; bf16_t* dst;
    __device__ const float* W(int t) const { return t ? Wu : Wg; } __device__ int ldw(int) const { return DFF; } __device__ int col(int job, int) const { return job * 16; }
    __device__ void store(int job, int row, int c, const float* v) const { dst[(size_t)row * DFF + job * 16 + c] = (bf16_t)f2bf(v[0] * sigmoidf_(v[0]) * v[1]); }
};
__global__ void __launch_bounds__(256) ngemm2(const bf16_t* __restrict__ ya, const bf16_t* __restrict__ yb, const bf16_t* __restrict__ yc, const bf16_t* __restrict__ G,
                                              const float* __restrict__ pa, const float* __restrict__ pb, const float* __restrict__ pc, bf16_t* __restrict__ Mo) {
    const int lane = threadIdx.x & 63, w = threadIdx.x >> 6, c = lane & 15, q = lane >> 4;
    const int row0 = blockIdx.x * 64 + w * 16, col0 = blockIdx.y * 16;
    f32x4 m = {0.f, 0.f, 0.f, 0.f};
    for (int br = 0; br < 3; ++br) {
        const bf16_t* A = br == 0 ? ya : br == 1 ? yb : yc; const float* P = br == 0 ? pa : br == 1 ? pb : pc; const int K = br == 1 ? GC : D;
        f32x4 acc = {0.f, 0.f, 0.f, 0.f};
        for (int k0 = 0; k0 < K; k0 += 32) {
            const bf16x8 a = *(const bf16x8*)(A + (size_t)(row0 + c) * K + k0 + 8 * q); bf16x8 b;
#pragma unroll
            for (int j = 0; j < 8; ++j) b[j] = (short)f2bf(P[(size_t)(k0 + 8 * q + j) * D + col0 + c]);
            acc = __builtin_amdgcn_mfma_f32_16x16x32_bf16(a, b, acc, 0, 0, 0);
        }
#pragma unroll
        for (int r = 0; r < 4; ++r) m[r] += bf2f(G[(size_t)br * T * D + (size_t)(row0 + 4 * q + r) * D + col0 + c]) * acc[r];
    }
#pragma unroll
    for (int r = 0; r < 4; ++r) Mo[(size_t)(row0 + 4 * q + r) * D + col0 + c] = (bf16_t)f2bf(m[r]);
}
__global__ void __launch_bounds__(256) k_ln(float* __restrict__ x, const float* __restrict__ g, const float* __restrict__ b, bf16_t* __restrict__ xb) {
    const int lane = threadIdx.x & 63, row = blockIdx.x * 4 + (threadIdx.x >> 6);
    float* xr = x + (size_t)row * D; f32x4 v[4]; float s = 0.f;
#pragma unroll
    for (int j = 0; j < 4; ++j) { v[j] = *(const f32x4*)(xr + j * 256 + lane * 4); s += (v[j].x + v[j].y) + (v[j].z + v[j].w); }
#pragma unroll
    for (int o = 1; o < 64; o <<= 1) s += __shfl_xor(s, o);
    const float mean = s * (1.f / D); float s2 = 0.f;
#pragma unroll
    for (int j = 0; j < 4; ++j) { v[j] = v[j] - mean; s2 += (v[j].x * v[j].x + v[j].y * v[j].y) + (v[j].z * v[j].z + v[j].w * v[j].w); }
#pragma unroll
    for (int o = 1; o < 64; o <<= 1) s2 += __shfl_xor(s2, o);
    const float rstd = 1.0f / sqrtf(s2 * (1.f / D) + LN_EPS);
#pragma unroll
    for (int j = 0; j < 4; ++j) { const int c0 = j * 256 + lane * 4; const f32x4 gg = *(const f32x4*)(g + c0), bb = *(const f32x4*)(b + c0);
        const f32x4 o = v[j] * rstd * gg + bb; *(f32x4*)(xr + c0) = o;
        uint2 p; p.x = f2bf(o.x) | (f2bf(o.y) << 16); p.y = f2bf(o.z) | (f2bf(o.w) << 16); *(uint2*)(xb + (size_t)row * D + c0) = p; }
}
__global__ void __launch_bounds__(256) k_conv(bf16_t* __restrict__ Bg, const bf16_t* __restrict__ Z, const float* __restrict__ cw) {
    const size_t idx = (size_t)blockIdx.x * 256 + threadIdx.x; const int row = (int)(idx >> 10), c = (int)(idx & 1023), t = row & (SEQ - 1);
    const float z0 = bf2f(Z[idx]), z1 = t >= 1 ? bf2f(Z[idx - D]) : 0.f, z2 = t >= 2 ? bf2f(Z[idx - 2 * D]) : 0.f;
    const float cv = cw[c] * z2 + cw[D + c] * z1 + cw[2 * D + c] * z0; Bg[idx] = (bf16_t)f2bf(bf2f(Bg[idx]) * cv);
}
__global__ void __launch_bounds__(64) k_attn(bf16_t* __restrict__ Q, const bf16_t* __restrict__ Kk, const bf16_t* __restrict__ Vv, float* __restrict__ lse, int dsh) {
    __shared__ float p[192];
    const int fr = blockIdx.x, h = blockIdx.y, lane = threadIdx.x; const int L = SEQ >> dsh, i = fr & (L - 1);
    const int nkeys = (i < 128 ? i : 128) + 1, k0row = fr - (nkeys - 1);
    float qv[64];
    { const bf16_t* qp = Q + (size_t)fr * GC + h * 64;
#pragma unroll
      for (int d8 = 0; d8 < 8; ++d8) { const bf16x8 t = *(const bf16x8*)(qp + d8 * 8);
#pragma unroll
          for (int j = 0; j < 8; ++j) qv[d8 * 8 + j] = bf2f((unsigned short)t[j]); } }
    float s[3]; float mx = -INFINITY;
#pragma unroll
    for (int r = 0; r < 3; ++r) { const int kk = r * 64 + lane; s[r] = -INFINITY;
        if (kk < nkeys) { const bf16_t* kp = Kk + (size_t)(k0row + kk) * GC + h * 64; float a = 0.f;
#pragma unroll
            for (int d8 = 0; d8 < 8; ++d8) { const bf16x8 t = *(const bf16x8*)(kp + d8 * 8);
#pragma unroll
                for (int j = 0; j < 8; ++j) a += qv[d8 * 8 + j] * bf2f((unsigned short)t[j]); }
            s[r] = a; }
        mx = fmaxf(mx, s[r]); }
#pragma unroll
    for (int o = 1; o < 64; o <<= 1) mx = fmaxf(mx, __shfl_xor(mx, o));
    float l = 0.f;
#pragma unroll
    for (int r = 0; r < 3; ++r) { const float e = (r * 64 + lane < nkeys) ? exp2f(s[r] - mx) : 0.f; p[r * 64 + lane] = e; l += e; }
#pragma unroll
    for (int o = 1; o < 64; o <<= 1) l += __shfl_xor(l, o);
    __syncthreads();
    float acc = 0.f;
    for (int kk = 0; kk < nkeys; ++kk) acc += p[kk] * bf2f(Vv[(size_t)(k0row + kk) * GC + h * 64 + lane]);
    Q[(size_t)fr * GC + h * 64 + lane] = (bf16_t)f2bf(acc / l);
    if (lane == 0) lse[(size_t)fr * NH + h] = mx + log2f(l);
}
__global__ void __launch_bounds__(256) k_combine(bf16_t* __restrict__ O, const float* __restrict__ lse) {
    const size_t idx = (size_t)blockIdx.x * 256 + threadIdx.x; const int row = (int)(idx >> 9), col = (int)(idx & 511), h = col >> 6;
    const int r1 = frow(row, 2), r2 = frow(row, 4);
    const float l0 = lse[(size_t)row * NH + h], l1 = lse[(size_t)T * NH + (size_t)r1 * NH + h], l2 = lse[(size_t)2 * T * NH + (size_t)r2 * NH + h];
    const float mx = fmaxf(l0, fmaxf(l1, l2)); const float w0 = exp2f(l0 - mx), w1 = exp2f(l1 - mx), w2 = exp2f(l2 - mx); const float inv = 1.0f / (w0 + w1 + w2);
    const float o = (w0 * bf2f(O[(size_t)row * GC + col]) + w1 * bf2f(O[QKV_STRIDE + (size_t)r1 * GC + col]) + w2 * bf2f(O[2 * QKV_STRIDE + (size_t)r2 * GC + col])) * inv;
    O[(size_t)row * GC + col] = (bf16_t)f2bf(o);
}
__global__ void __launch_bounds__(256) k_vstats(const bf16_t* __restrict__ V2, float* __restrict__ st) {
    const int lane = threadIdx.x & 63, row = blockIdx.x * 4 + (threadIdx.x >> 6);
    float v[16]; float s = 0.f;
#pragma unroll
    for (int j = 0; j < 2; ++j) { const bf16x8 t = *(const bf16x8*)(V2 + (size_t)row * D + j * 512 + lane * 8);
#pragma unroll
        for (int k = 0; k < 8; ++k) { v[j * 8 + k] = bf2f((unsigned short)t[k]); s += v[j * 8 + k]; } }
#pragma unroll
    for (int o = 1; o < 64; o <<= 1) s += __shfl_xor(s, o);
    const float mean = s * (1.f / D); float s2 = 0.f;
#pragma unroll
    for (int k = 0; k < 16; ++k) { const float d = v[k] - mean; s2 += d * d; }
#pragma unroll
    for (int o = 1; o < 64; o <<= 1) s2 += __shfl_xor(s2, o);
    if (lane == 0) { st[row * 2] = mean; st[row * 2 + 1] = 1.0f / sqrtf(s2 * (1.f / D) + LN_EPS); }
}
__global__ void __launch_bounds__(256) k_gmlp(bf16_t* __restrict__ U, const bf16_t* __restrict__ V2, const float* __restrict__ st, const float* __restrict__ lg, const float* __restrict__ lb,
                                               const float* __restrict__ ws, const float* __restrict__ bs) {
    const size_t idx = (size_t)blockIdx.x * 256 + threadIdx.x; const int row = (int)(idx >> 10), c = (int)(idx & 1023), g = c >> 7, i = row & 127, r0 = row - i;
    const float gam = lg[c], bet = lb[c]; const float* wr = ws + ((size_t)g * 128 + i) * 128; float sp = bs[g * 128 + i];
    for (int j = 0; j <= i; ++j) { const float vl = (bf2f(V2[(size_t)(r0 + j) * D + c]) - st[(r0 + j) * 2]) * st[(r0 + j) * 2 + 1] * gam + bet; sp += wr[j] * vl; }
    U[idx] = (bf16_t)f2bf(bf2f(U[idx]) * sp);
}

extern "C" void kernel_launch(void* const* d_in, const int* in_sizes, int n_in, void* d_out, int out_size, void* d_ws, size_t ws_size, hipStream_t stream) {
    if (n_in != 19 || out_size != T * D || ws_size < WS_END) { fprintf(stderr, "kernel_launch: unexpected shapes (n_in %d, out %d, ws %zu)\n", n_in, out_size, ws_size); return; }
    const float* x = (const float*)d_in[0]; const int* pos = (const int*)d_in[1];
    unsigned char* ws = (unsigned char*)d_ws; float* out = (float*)d_out;
    float* cs = (float*)(ws + WS_ROPE); float* sn = cs + (size_t)T * 32; float* lse = (float*)(ws + WS_LSE); float* st = (float*)(ws + WS_STAT);
    bf16_t* XB = (bf16_t*)(ws + WS_XB); bf16_t* BG = (bf16_t*)(ws + WS_BG); bf16_t* Z = (bf16_t*)(ws + WS_Z); bf16_t* Q = (bf16_t*)(ws + WS_Q); bf16_t* Kb = (bf16_t*)(ws + WS_K); bf16_t* Vb = (bf16_t*)(ws + WS_V);
    bf16_t* U = (bf16_t*)(ws + WS_U); bf16_t* V2 = (bf16_t*)(ws + WS_V2); bf16_t* G = (bf16_t*)(ws + WS_G); bf16_t* Mb = (bf16_t*)(ws + WS_M); bf16_t* H = (bf16_t*)(ws + WS_H);
    k_rope_table<<<T * 32 / 256, 256, 0, stream>>>(pos, cs, sn);
    k_cvt_x<<<T * D / 1024, 256, 0, stream>>>(x, XB);
    for (int l = 0; l < DEPTH; ++l) {
        const float* w_in = (const float*)d_in[2] + (size_t)l * D * NIN; const float* conv_w = (const float*)d_in[3] + (size_t)l * 3 * D;
        const float* glg = (const float*)d_in[4] + (size_t)l * D; const float* glb = (const float*)d_in[5] + (size_t)l * D;
        const float* w_s = (const float*)d_in[6] + (size_t)l * 8 * 128 * 128; const float* b_s = (const float*)d_in[7] + (size_t)l * 8 * 128;
        const float* p_a = (const float*)d_in[8] + (size_t)l * D * D; const float* p_b = (const float*)d_in[9] + (size_t)l * GC * D; const float* p_c = (const float*)d_in[10] + (size_t)l * D * D;
        const float* w_o = (const float*)d_in[11] + (size_t)l * D * D; const float* ln1g = (const float*)d_in[12] + (size_t)l * D; const float* ln1b = (const float*)d_in[13] + (size_t)l * D;
        const float* w_g = (const float*)d_in[14] + (size_t)l * D * DFF; const float* w_u = (const float*)d_in[15] + (size_t)l * D * DFF; const float* w_d = (const float*)d_in[16] + (size_t)l * DFF * D;
        const float* ln2g = (const float*)d_in[17] + (size_t)l * D; const float* ln2b = (const float*)d_in[18] + (size_t)l * D;
        const float* resid = l == 0 ? x : out;
        const dim3 blk(256);
        ngemm<NE1<M_PLAIN>><<<dim3(T / 64, 64), blk, 0, stream>>>(XB, D, NE1<M_PLAIN>{w_in, NIN, C_B, BG, D, 0});
        ngemm<NEz><<<dim3(T / 64, 64), blk, 0, stream>>>(XB, D, NEz{w_in, Z});
        for (int g = 0; g < 3; ++g) { const int dsh = 2 * g, cq = C_ATT + 3 * g * GC;
            ngemm<NErope><<<dim3(T / 64, 16), blk, 0, stream>>>(XB, D, NErope{w_in, cq, Q + g * QKV_STRIDE, dsh, QSCALE, cs, sn});
            ngemm<NErope><<<dim3(T / 64, 16), blk, 0, stream>>>(XB, D, NErope{w_in, cq + GC, Kb + g * QKV_STRIDE, dsh, 1.0f, cs, sn});
            ngemm<NE1<M_FOLD>><<<dim3(T / 64, 32), blk, 0, stream>>>(XB, D, NE1<M_FOLD>{w_in, NIN, cq + 2 * GC, Vb + g * QKV_STRIDE, GC, dsh}); }
        ngemm<NE1<M_GELU>><<<dim3(T / 64, 64), blk, 0, stream>>>(XB, D, NE1<M_GELU>{w_in, NIN, C_U, U, D, 0});
        ngemm<NE1<M_GELU>><<<dim3(T / 64, 64), blk, 0, stream>>>(XB, D, NE1<M_GELU>{w_in, NIN, C_V, V2, D, 0});
        k_conv<<<T * D / 256, 256, 0, stream>>>(BG, Z, conv_w);
        for (int g = 0; g < 3; ++g) k_attn<<<dim3(T, NH), 64, 0, stream>>>(Q + g * QKV_STRIDE, Kb + g * QKV_STRIDE, Vb + g * QKV_STRIDE, lse + (size_t)g * T * NH, 2 * g);
        k_vstats<<<T / 4, 256, 0, stream>>>(V2, st);
        k_gmlp<<<T * D / 256, 256, 0, stream>>>(U, V2, st, glg, glb, w_s, b_s);
        k_combine<<<T * GC / 256, 256, 0, stream>>>(Q, lse);
        for (int j = 0; j < 3; ++j) ngemm<NE1<M_SIG>><<<dim3(T / 64, 64), blk, 0, stream>>>(XB, D, NE1<M_SIG>{w_in, NIN, C_GATE + j * D, G + (size_t)j * T * D, D, 0});
        ngemm2<<<dim3(T / 64, 64), blk, 0, stream>>>(BG, Q, U, G, p_a, p_b, p_c, Mb);
        ngemm<NEres><<<dim3(T / 64, 64), blk, 0, stream>>>(Mb, D, NEres{w_o, resid, out});
        k_ln<<<T / 4, 256, 0, stream>>>(out, ln1g, ln1b, XB);
        ngemm<NEffn><<<dim3(T / 64, DFF / 16), blk, 0, stream>>>(XB, D, NEffn{w_g, w_u, H});
        ngemm<NEres><<<dim3(T / 64, 64), blk, 0, stream>>>(H, DFF, NEres{w_d, out, out});
        k_ln<<<T / 4, 256, 0, stream>>>(out, ln2g, ln2b, XB);
    }
}
```
